# Optimizing an MI355X kernel written in HIP

```python
import math
import jax
import jax.numpy as jnp
from jax import lax
import numpy as np

D_MODEL = 1024
BATCH = 16
SEQ = 2048
DEPTH = 1

D_MIX = D_MODEL
ATT_HEADS = 4
ATT_QK_DIM = 64
ATT_V_DIM = 2 * ATT_QK_DIM
D_ATT = ATT_HEADS * ATT_V_DIM
M_HEADS = 4
D_MLSTM = D_MIX - D_ATT
M_DIM = D_MLSTM // M_HEADS
D_PROJ = 3 * D_ATT + 4 * D_MLSTM + 2 * M_HEADS
CONV_W = 4
CHUNK = 64
Q_BLOCK = 128
N_BUCKETS = 32
MAX_DIST = 128
N_KEYS = 128
N_EXPERTS = N_KEYS * N_KEYS
PEER_HEADS = 8
PEER_TOPK = 16
PEER_QDIM = 256
PEER_BLOCK = 128
EPS = 1e-6

kernel_name = 'hybrid_diffattn_mlstm_peer'


def _rms(x):
    xf = x.astype(jnp.float32)
    return xf * lax.rsqrt(jnp.mean(xf * xf, axis=-1, keepdims=True) + EPS)


def rmsnorm(x, g):
    return _rms(x).astype(x.dtype) * g


def modulate(h, shift, scale):
    return h * (1.0 + scale[:, None, :]) + shift[:, None, :]


def rel_bucket(n):
    max_exact = N_BUCKETS // 2
    nf = jnp.maximum(n, 1).astype(jnp.float32)
    large = max_exact + (jnp.log(nf / max_exact) / math.log(MAX_DIST / max_exact)
                         * (N_BUCKETS - max_exact)).astype(jnp.int32)
    large = jnp.minimum(large, N_BUCKETS - 1)
    return jnp.where(n < max_exact, n, large)


def causal_conv(x, w, b):
    S = x.shape[1]
    xp = jnp.pad(x, ((0, 0), (CONV_W - 1, 0), (0, 0)))
    out = xp[:, 0:S] * w[0]
    for j in range(1, CONV_W):
        out = out + xp[:, j:j + S] * w[j]
    return out + b


def diff_attention(q, k, v, rel_bias, lam_q1, lam_k1, lam_q2, lam_k2, sub_g, lambda_init):
    B, S = q.shape[0], q.shape[1]
    lam = (jnp.exp(jnp.sum(lam_q1 * lam_k1).astype(jnp.float32))
           - jnp.exp(jnp.sum(lam_q2 * lam_k2).astype(jnp.float32)) + lambda_init)
    scale = ATT_QK_DIM ** -0.5
    outs = []
    for qb in range(S // Q_BLOCK):
        s0 = qb * Q_BLOCK
        s1 = s0 + Q_BLOCK
        logits = jnp.einsum('bqhtd,bkhtd->bhtqk', q[:, s0:s1], k[:, :s1]).astype(jnp.float32) * scale
        rel = (s0 + jnp.arange(Q_BLOCK, dtype=jnp.int32))[:, None] - jnp.arange(s1, dtype=jnp.int32)[None, :]
        bias = jnp.transpose(rel_bias[rel_bucket(jnp.maximum(rel, 0))], (2, 0, 1)).astype(jnp.float32)
        logits = jnp.where(rel >= 0, logits + bias[None, :, None], jnp.finfo(jnp.float32).min)
        p = jax.nn.softmax(logits, axis=-1)
        a = p[:, :, 0] - lam * p[:, :, 1]
        outs.append(jnp.einsum('bhqk,bkhe->bqhe', a.astype(v.dtype), v[:, :s1]))
    o = jnp.concatenate(outs, axis=1)
    o = _rms(o).astype(v.dtype) * sub_g * (1.0 - lambda_init)
    return o.reshape(B, S, D_ATT)


def mlstm_chunkwise(q, k, v, i_pre, f_pre):
    B, S, H, d = q.shape
    NC = S // CHUNK

    def chunks(t):
        return t.reshape(B, NC, CHUNK, H, d).transpose(0, 3, 1, 2, 4)

    q, k, v = chunks(q), chunks(k), chunks(v)
    ig = i_pre.reshape(B, NC, CHUNK, H).transpose(0, 3, 1, 2)
    logf = jax.nn.log_sigmoid(f_pre).reshape(B, NC, CHUNK, H).transpose(0, 3, 1, 2)
    b = jnp.cumsum(logf, axis=-1)
    b_last = b[..., -1]
    a_end = b_last[..., None] - b + ig

    def step(carry, xs):
        C, n, m = carry
        k_c, v_c, a_c, bl = xs
        m_new = jnp.maximum(bl + m, jnp.max(a_c, axis=-1))
        decay = jnp.exp(bl + m - m_new)
        w = jnp.exp(a_c - m_new[..., None])
        C_new = decay[..., None, None] * C + jnp.einsum('bhl,bhld,bhle->bhde', w, k_c, v_c)
        n_new = decay[..., None] * n + jnp.einsum('bhl,bhld->bhd', w, k_c)
        return (C_new, n_new, m_new), (C, n, m)

    init = (jnp.zeros((B, H, d, d), jnp.float32), jnp.zeros((B, H, d), jnp.float32),
            jnp.zeros((B, H), jnp.float32))
    xs = (k.transpose(2, 0, 1, 3, 4), v.transpose(2, 0, 1, 3, 4),
          a_end.transpose(2, 0, 1, 3), b_last.transpose(2, 0, 1))
    _, (C_prev, n_prev, m_prev) = lax.scan(step, init, xs)
    C_prev = C_prev.transpose(1, 2, 0, 3, 4)
    n_prev = n_prev.transpose(1, 2, 0, 3)
    m_prev = m_prev.transpose(1, 2, 0)

    causal = jnp.tril(jnp.ones((CHUNK, CHUNK), dtype=bool))
    logD = jnp.where(causal, b[..., :, None] - b[..., None, :] + ig[..., None, :], -jnp.inf)
    m_inter = b + m_prev[..., None]
    m_j = jnp.maximum(jnp.max(logD, axis=-1), m_inter)
    W = jnp.exp(logD - m_j[..., None])
    Sqk = jnp.einsum('bhcjd,bhcsd->bhcjs', q, k) * W
    inter = jnp.exp(m_inter - m_j)
    num = (jnp.einsum('bhcjs,bhcse->bhcje', Sqk, v)
           + inter[..., None] * jnp.einsum('bhcjd,bhcde->bhcje', q, C_prev))
    den = jnp.sum(Sqk, axis=-1) + inter * jnp.einsum('bhcjd,bhcd->bhcj', q, n_prev)
    h = num / jnp.maximum(jnp.abs(den), jnp.exp(-m_j))[..., None]
    return h.transpose(0, 2, 3, 1, 4).reshape(B, S, H, d)


def hybrid_mixer(h, w_in, conv_w, conv_b, b_igate, b_fgate, lam_q1, lam_k1, lam_q2, lam_k2,
                 diff_sub_g, mlstm_norm_g, w_out, rel_bias, lambda_init):
    B, S, _ = h.shape
    proj = h @ w_in
    sizes = [D_ATT, D_ATT, D_ATT, D_MLSTM, D_MLSTM, D_MLSTM, D_MLSTM, M_HEADS, M_HEADS]
    splits = np.cumsum(sizes)[:-1].tolist()
    dq, dk, dv, mq, mk, mv, mo, mi, mf = jnp.split(proj, splits, axis=-1)
    att = diff_attention(dq.reshape(B, S, ATT_HEADS, 2, ATT_QK_DIM),
                         dk.reshape(B, S, ATT_HEADS, 2, ATT_QK_DIM),
                         dv.reshape(B, S, ATT_HEADS, ATT_V_DIM),
                         rel_bias, lam_q1, lam_k1, lam_q2, lam_k2, diff_sub_g, lambda_init)
    qk = jax.nn.silu(causal_conv(jnp.concatenate([mq, mk], axis=-1), conv_w, conv_b))
    mq, mk = jnp.split(qk, 2, axis=-1)
    f32 = jnp.float32
    hm = mlstm_chunkwise(mq.reshape(B, S, M_HEADS, M_DIM).astype(f32),
                         (mk * (M_DIM ** -0.5)).reshape(B, S, M_HEADS, M_DIM).astype(f32),
                         mv.reshape(B, S, M_HEADS, M_DIM).astype(f32),
                         (mi + b_igate).astype(f32), (mf + b_fgate).astype(f32))
    hm = jax.nn.sigmoid(mo.astype(f32)).reshape(B, S, M_HEADS, M_DIM) * hm
    hm = _rms(hm).reshape(B, S, D_MLSTM).astype(h.dtype) * mlstm_norm_g
    mix = jnp.concatenate([att, hm], axis=-1)
    return mix @ w_out


def peer(h, w_q, sub_keys, u, v):
    B, S, D = h.shape
    T = B * S
    ht = h.reshape(T, D)
    q = (ht @ w_q).reshape(T, PEER_HEADS, 2, PEER_QDIM // 2)
    s = jnp.einsum('thpd,hpkd->thpk', q, sub_keys).astype(jnp.float32)
    sv, si = lax.top_k(s, PEER_TOPK)
    cand = sv[:, :, 0, :, None] + sv[:, :, 1, None, :]
    cand_idx = si[:, :, 0, :, None] * N_KEYS + si[:, :, 1, None, :]
    top_s, pos = lax.top_k(cand.reshape(T, PEER_HEADS, PEER_TOPK * PEER_TOPK), PEER_TOPK)
    idx = jnp.take_along_axis(cand_idx.reshape(T, PEER_HEADS, PEER_TOPK * PEER_TOPK), pos, axis=-1)
    g = jax.nn.softmax(top_s, axis=-1)
    nb = T // PEER_BLOCK

    def block(args):
        hb, ib, gb = args
        act = jax.nn.gelu(jnp.einsum('thkd,td->thk', u[ib], hb))
        return jnp.einsum('thk,thkd->td', (gb * act).astype(hb.dtype), v[ib])

    out = lax.map(block, (ht.reshape(nb, PEER_BLOCK, D),
                          idx.reshape(nb, PEER_BLOCK, PEER_HEADS, PEER_TOPK),
                          g.reshape(nb, PEER_BLOCK, PEER_HEADS, PEER_TOPK)))
    return out.reshape(B, S, D)


def setup_inputs(seed: int = 0) -> dict:
    key = jax.random.key(seed)
    ks = jax.random.split(key, 24)
    L, D = DEPTH, D_MODEL

    def nrm(k, shape, s):
        return jax.random.normal(k, shape, jnp.float32) * s

    return {
        'x': nrm(ks[0], (BATCH, SEQ, D), 1.0),
        'c': nrm(ks[1], (BATCH, D), 1.0),
        'w_ada': nrm(ks[2], (L, D, 6 * D), 0.5 * D ** -0.5),
        'b_ada': nrm(ks[3], (L, 6 * D), 0.02),
        'norm1_g': 1.0 + nrm(ks[4], (L, D), 0.02),
        'norm2_g': 1.0 + nrm(ks[5], (L, D), 0.02),
        'w_in': nrm(ks[6], (L, D, D_PROJ), D ** -0.5),
        'conv_w': nrm(ks[7], (L, CONV_W, 2 * D_MLSTM), CONV_W ** -0.5),
        'conv_b': nrm(ks[8], (L, 2 * D_MLSTM), 0.02),
        'b_igate': nrm(ks[9], (L, M_HEADS), 0.1),
        'b_fgate': jnp.linspace(3.0, 6.0, M_HEADS, dtype=jnp.float32)[None, :] + nrm(ks[10], (L, M_HEADS), 0.1),
        'lam_q1': nrm(ks[11], (L, ATT_QK_DIM), 0.1),
        'lam_k1': nrm(ks[12], (L, ATT_QK_DIM), 0.1),
        'lam_q2': nrm(ks[13], (L, ATT_QK_DIM), 0.1),
        'lam_k2': nrm(ks[14], (L, ATT_QK_DIM), 0.1),
        'diff_sub_g': 1.0 + nrm(ks[15], (L, ATT_V_DIM), 0.02),
        'mlstm_norm_g': 1.0 + nrm(ks[16], (L, D_MLSTM), 0.02),
        'w_out': nrm(ks[17], (L, D_MIX, D), D_MIX ** -0.5),
        'peer_w_q': nrm(ks[18], (L, D, PEER_HEADS * PEER_QDIM), D ** -0.5),
        'peer_sub_keys': nrm(ks[19], (L, PEER_HEADS, 2, N_KEYS, PEER_QDIM // 2), (PEER_QDIM // 2) ** -0.5),
        'peer_u': nrm(ks[20], (L, N_EXPERTS, D), D ** -0.5),
        'peer_v': nrm(ks[21], (L, N_EXPERTS, D), PEER_HEADS ** -0.5),
        'rel_bias': nrm(ks[22], (N_BUCKETS, ATT_HEADS), 0.5),
        'final_g': 1.0 + nrm(ks[23], (D,), 0.02),
    }


def reference(x, c, w_ada, b_ada, norm1_g, norm2_g, w_in, conv_w, conv_b, b_igate, b_fgate,
              lam_q1, lam_k1, lam_q2, lam_k2, diff_sub_g, mlstm_norm_g, w_out,
              peer_w_q, peer_sub_keys, peer_u, peer_v, rel_bias, final_g):
    cond = jax.nn.silu(c)
    for l in range(DEPTH):
        lambda_init = 0.8 - 0.6 * math.exp(-0.3 * l)
        mod = cond @ w_ada[l] + b_ada[l]
        sh1, sc1, g1, sh2, sc2, g2 = jnp.split(mod, 6, axis=-1)
        h = modulate(rmsnorm(x, norm1_g[l]), sh1, sc1)
        y = hybrid_mixer(h, w_in[l], conv_w[l], conv_b[l], b_igate[l], b_fgate[l],
                         lam_q1[l], lam_k1[l], lam_q2[l], lam_k2[l], diff_sub_g[l],
                         mlstm_norm_g[l], w_out[l], rel_bias, lambda_init)
        x = x + g1[:, None, :] * y
        h = modulate(rmsnorm(x, norm2_g[l]), sh2, sc2)
        x = x + g2[:, None, :] * peer(h, peer_w_q[l], peer_sub_keys[l], peer_u[l], peer_v[l])
    return rmsnorm(x, final_g)
```

```cpp
#include <hip/hip_runtime.h>
#include <cstdio>
#include <cstdint>
#include <cmath>

constexpr int D = 1024, BATCH = 16, SEQ = 2048, T = BATCH * SEQ;
constexpr int DPROJ = 3592;
constexpr int NKEYS = 128, PH = 8, PK = 16;
constexpr float EPS = 1e-6f;
constexpr float LAMBDA_INIT = 0.2f;

constexpr int GB = 4, GT = GB * SEQ;

__device__ __forceinline__ float wave_sum(float v) {
#pragma unroll
    for (int o = 1; o < 64; o <<= 1) v += __shfl_xor(v, o);
    return v;
}
__device__ __forceinline__ float wave_max(float v) {
#pragma unroll
    for (int o = 1; o < 64; o <<= 1) v = fmaxf(v, __shfl_xor(v, o));
    return v;
}
__device__ __forceinline__ float silu_f(float x) { return x / (1.f + expf(-x)); }
__device__ __forceinline__ float sigmoid_f(float x) { return 1.f / (1.f + expf(-x)); }
__device__ __forceinline__ float logsigmoid_f(float x) { return fminf(x, 0.f) - log1pf(expf(-fabsf(x))); }
__device__ __forceinline__ float gelu_tanh_f(float x) {
    const float k = 0.7978845608028654f;
    return 0.5f * x * (1.f + tanhf(k * (x + 0.044715f * x * x * x)));
}

__global__ void __launch_bounds__(256) k_mod(const float* c, const float* w_ada, const float* b_ada, float* mod) {
    __shared__ float sc[16 * 1024];
    for (int i = threadIdx.x; i < 16 * 1024; i += 256) sc[i] = silu_f(c[i]);
    __syncthreads();
    const int n = blockIdx.x * 256 + threadIdx.x;
    float acc[16];
#pragma unroll
    for (int b = 0; b < 16; ++b) acc[b] = 0.f;
    for (int k = 0; k < 1024; ++k) {
        const float w = w_ada[(size_t)k * 6144 + n];
#pragma unroll
        for (int b = 0; b < 16; ++b) acc[b] += sc[b * 1024 + k] * w;
    }
#pragma unroll
    for (int b = 0; b < 16; ++b) mod[b * 6144 + n] = acc[b] + b_ada[n];
}

__global__ void __launch_bounds__(256) k_norm_mod(const float* x, const float* g, const float* mod, int sh_off, int sc_off,
                                                  float* h, int tok0, int ntok) {
    const int wave = (blockIdx.x * 256 + threadIdx.x) >> 6, lane = threadIdx.x & 63;
    if (wave >= ntok) return;
    const int t = tok0 + wave, b = t / SEQ;
    const float* xr = x + (size_t)t * D;
    float v[16]; float ss = 0.f;
#pragma unroll
    for (int j = 0; j < 16; ++j) { v[j] = xr[lane + 64 * j]; ss += v[j] * v[j]; }
    ss = wave_sum(ss);
    const float r = rsqrtf(ss * (1.f / D) + EPS);
    float* hr = h + (size_t)wave * D;
#pragma unroll
    for (int j = 0; j < 16; ++j) {
        const int col = lane + 64 * j;
        hr[col] = (v[j] * r * g[col]) * (1.f + mod[b * 6144 + sc_off + col]) + mod[b * 6144 + sh_off + col];
    }
}

__global__ void __launch_bounds__(256) k_gemm(const float* A, int lda, const float* B, int ldb, float* C, int ldc, int M, int N, int K,
                                              size_t sA, size_t sB, size_t sC, int transB) {
    __shared__ float As[16][64 + 1];
    __shared__ float Bs[16][64 + 1];
    A += blockIdx.z * sA; B += blockIdx.z * sB; C += blockIdx.z * sC;
    const int tx = threadIdx.x & 15, ty = threadIdx.x >> 4;
    const int m0 = blockIdx.y * 64, n0 = blockIdx.x * 64;
    float acc[4][4];
#pragma unroll
    for (int i = 0; i < 4; ++i)
#pragma unroll
        for (int j = 0; j < 4; ++j) acc[i][j] = 0.f;
    for (int k0 = 0; k0 < K; k0 += 16) {
        for (int i = threadIdx.x; i < 64 * 16; i += 256) {
            const int m = i >> 4, k = i & 15;
            As[k][m] = A[(size_t)(m0 + m) * lda + k0 + k];
        }
        if (!transB) {
            for (int i = threadIdx.x; i < 64 * 16; i += 256) {
                const int k = i >> 6, n = i & 63;
                Bs[k][n] = (n0 + n < N) ? B[(size_t)(k0 + k) * ldb + n0 + n] : 0.f;
            }
        } else {
            for (int i = threadIdx.x; i < 64 * 16; i += 256) {
                const int n = i >> 4, k = i & 15;
                Bs[k][n] = (n0 + n < N) ? B[(size_t)(n0 + n) * ldb + k0 + k] : 0.f;
            }
        }
        __syncthreads();
#pragma unroll
        for (int k = 0; k < 16; ++k) {
            float a[4], b[4];
#pragma unroll
            for (int i = 0; i < 4; ++i) a[i] = As[k][ty * 4 + i];
#pragma unroll
            for (int j = 0; j < 4; ++j) b[j] = Bs[k][tx * 4 + j];
#pragma unroll
            for (int i = 0; i < 4; ++i)
#pragma unroll
                for (int j = 0; j < 4; ++j) acc[i][j] += a[i] * b[j];
        }
        __syncthreads();
    }
#pragma unroll
    for (int i = 0; i < 4; ++i)
#pragma unroll
        for (int j = 0; j < 4; ++j) {
            const int n = n0 + tx * 4 + j;
            if (n < N) C[(size_t)(m0 + ty * 4 + i) * ldc + n] = acc[i][j];
        }
}

__device__ __forceinline__ int rel_bucket(int n) {
    if (n < 16) return n;
    const int th[15] = {19, 21, 24, 27, 31, 35, 40, 46, 52, 59, 67, 77, 87, 99, 113};
    int bkt = 16;
#pragma unroll
    for (int i = 0; i < 15; ++i) bkt += (n >= th[i]) ? 1 : 0;
    return bkt;
}

__global__ void __launch_bounds__(256) k_attn(const float* proj, const float* rel_bias, const float* lq1, const float* lk1, const float* lq2, const float* lk2,
                                              const float* sub_g, float* mix) {
    __shared__ float qsh[4][128];
    const int wv = threadIdx.x >> 6;
    const int gw = (blockIdx.x * 256 + threadIdx.x) >> 6, lane = threadIdx.x & 63;
    const int q = gw % SEQ, h = (gw / SEQ) % 4, bl = gw / (SEQ * 4);
    float s1 = lq1[lane] * lk1[lane], s2 = lq2[lane] * lk2[lane];
    s1 = wave_sum(s1); s2 = wave_sum(s2);
    const float lam = expf(s1) - expf(s2) + LAMBDA_INIT;
    const float* base = proj + (size_t)bl * SEQ * DPROJ;
    const float* qrow = base + (size_t)q * DPROJ + h * 128;
    qsh[wv][lane] = qrow[lane]; qsh[wv][64 + lane] = qrow[64 + lane];
    __syncthreads();
    const float* qs = qsh[wv];
    float m0 = -INFINITY, m1 = -INFINITY, l0 = 0.f, l1 = 0.f;
    for (int k0 = 0; k0 <= q; k0 += 64) {
        const int k = k0 + lane, kc = min(k, q);
        const float* krow = base + (size_t)kc * DPROJ + 512 + h * 128;
        float a0 = 0.f, a1 = 0.f;
        for (int d = 0; d < 64; ++d) { a0 += qs[d] * krow[d]; a1 += qs[64 + d] * krow[64 + d]; }
        const float bias = rel_bias[rel_bucket(q - kc) * 4 + h];
        a0 = (k <= q) ? a0 * 0.125f + bias : -INFINITY;
        a1 = (k <= q) ? a1 * 0.125f + bias : -INFINITY;
        const float nm0 = fmaxf(m0, wave_max(a0)), nm1 = fmaxf(m1, wave_max(a1));
        const float p0 = expf(a0 - nm0), p1 = expf(a1 - nm1);
        l0 = l0 * expf(m0 - nm0) + wave_sum(p0);
        l1 = l1 * expf(m1 - nm1) + wave_sum(p1);
        m0 = nm0; m1 = nm1;
    }
    float o0 = 0.f, o1 = 0.f;
    for (int k0 = 0; k0 <= q; k0 += 64) {
        const int k = k0 + lane, kc = min(k, q);
        const float* krow = base + (size_t)kc * DPROJ + 512 + h * 128;
        float a0 = 0.f, a1 = 0.f;
        for (int d = 0; d < 64; ++d) { a0 += qs[d] * krow[d]; a1 += qs[64 + d] * krow[64 + d]; }
        const float bias = rel_bias[rel_bucket(q - kc) * 4 + h];
        a0 = a0 * 0.125f + bias; a1 = a1 * 0.125f + bias;
        const float a = (k <= q) ? expf(a0 - m0) / l0 - lam * expf(a1 - m1) / l1 : 0.f;
        const int kmax = min(64, q - k0 + 1);
        for (int kk = 0; kk < kmax; ++kk) {
            const float ak = __shfl(a, kk);
            const float* vrow = base + (size_t)(k0 + kk) * DPROJ + 1024 + h * 128;
            o0 += ak * vrow[lane]; o1 += ak * vrow[64 + lane];
        }
    }
    const float ss = wave_sum(o0 * o0 + o1 * o1);
    const float r = rsqrtf(ss * (1.f / 128.f) + EPS) * (1.f - LAMBDA_INIT);
    float* orow = mix + ((size_t)bl * SEQ + q) * 1024 + h * 128;
    orow[lane] = o0 * r * sub_g[lane];
    orow[64 + lane] = o1 * r * sub_g[64 + lane];
}

constexpr int ML_LDS = (128 * 64 + 2 * 64 * 128 + 64 * 64 + 64 * 64 + 128 + 64 * 9) * 4;
__global__ void __launch_bounds__(256) k_mlstm(const float* proj, const float* conv_w, const float* conv_b, const float* b_ig, const float* b_fg,
                                               float* mix) {
    extern __shared__ float sm[];
    float* C = sm;
    float* qs = C + 128 * 64;
    float* ks = qs + 64 * 128;
    float* vs = ks + 64 * 128;
    float* Sq = vs + 64 * 64;
    float* nst = Sq + 64 * 64;
    float* bcum = nst + 128;
    float* igs = bcum + 64;
    float* mj = igs + 64;
    float* inter = mj + 64;
    float* den = inter + 64;
    float* wst = den + 64;
    float* misc = wst + 64;
    float* qn = misc + 64;
    const int tid = threadIdx.x, lane = tid & 63, wv = tid >> 6;
    const int eh = blockIdx.x & 1, h = (blockIdx.x >> 1) % 4, bl = blockIdx.x / 8;
    const float* base = proj + (size_t)bl * SEQ * DPROJ;
    for (int i = tid; i < 128 * 64; i += 256) C[i] = 0.f;
    if (tid < 128) nst[tid] = 0.f;
    if (tid == 0) misc[0] = 0.f;
    __syncthreads();
    for (int c = 0; c < 32; ++c) {
        const int s0 = c * 64;
        for (int i = tid; i < 64 * 128; i += 256) {
            const int l = i >> 7, d = i & 127, s = s0 + l;
            const int chq = h * 128 + d, chk = 512 + h * 128 + d;
            float aq = conv_b[chq], ak = conv_b[chk];
#pragma unroll
            for (int j = 0; j < 4; ++j) {
                const int sp = s + j - 3;
                if (sp >= 0) {
                    aq += base[(size_t)sp * DPROJ + 1536 + chq] * conv_w[j * 1024 + chq];
                    ak += base[(size_t)sp * DPROJ + 1536 + chk] * conv_w[j * 1024 + chk];
                }
            }
            qs[i] = silu_f(aq);
            ks[i] = silu_f(ak) * 0.08838834764831845f;
        }
        for (int i = tid; i < 64 * 64; i += 256) {
            const int l = i >> 6, e = i & 63;
            vs[i] = base[(size_t)(s0 + l) * DPROJ + 2560 + h * 128 + eh * 64 + e];
        }
        if (tid < 64) {
            const int s = s0 + tid;
            igs[tid] = base[(size_t)s * DPROJ + 3584 + h] + b_ig[h];
            const float f = base[(size_t)s * DPROJ + 3588 + h] + b_fg[h];
            float lf = logsigmoid_f(f);
#pragma unroll
            for (int o = 1; o < 64; o <<= 1) { const float t2 = __shfl_up(lf, o); if (tid >= o) lf += t2; }
            bcum[tid] = lf;
        }
        __syncthreads();
        const float m_prev = misc[0];
        const float bl_ = bcum[63];
        if (tid < 64) {
            const int j = tid;
            float mx = -INFINITY;
            for (int s = 0; s <= j; ++s) mx = fmaxf(mx, bcum[j] - bcum[s] + igs[s]);
            const float mint = bcum[j] + m_prev;
            const float m = fmaxf(mx, mint);
            mj[j] = m; inter[j] = expf(mint - m);
        }
        __syncthreads();
        for (int i = tid; i < 64 * 64; i += 256) {
            const int j = i >> 6, s = i & 63;
            float v = 0.f;
            if (s <= j) {
                float dot = 0.f;
                for (int d = 0; d < 128; ++d) dot += qs[j * 128 + d] * ks[s * 128 + d];
                v = dot * expf(bcum[j] - bcum[s] + igs[s] - mj[j]);
            }
            Sq[i] = v;
        }
        if (tid < 64) {
            float dot = 0.f;
            for (int d = 0; d < 128; ++d) dot += qs[tid * 128 + d] * nst[d];
            qn[tid] = dot;
        }
        __syncthreads();
        if (tid < 64) {
            float sden = 0.f;
            for (int s = 0; s < 64; ++s) sden += Sq[tid * 64 + s];
            sden += inter[tid] * qn[tid];
            den[tid] = fmaxf(fabsf(sden), expf(-mj[tid]));
        }
        __syncthreads();
        for (int j = wv; j < 64; j += 4) {
            float a = 0.f;
            for (int s = 0; s <= j; ++s) a += Sq[j * 64 + s] * vs[s * 64 + lane];
            float b2 = 0.f;
            for (int d = 0; d < 128; ++d) b2 += qs[j * 128 + d] * C[d * 64 + lane];
            const float hv = (a + inter[j] * b2) / den[j];
            const int col = h * 128 + eh * 64 + lane;
            const float mo = base[(size_t)(s0 + j) * DPROJ + 3072 + col];
            mix[((size_t)bl * SEQ + s0 + j) * 1024 + 512 + col] = sigmoid_f(mo) * hv;
        }
        if (tid < 64) {
            const float a_end = bl_ - bcum[tid] + igs[tid];
            const float mx = wave_max(a_end);
            const float m_new = fmaxf(bl_ + m_prev, mx);
            wst[tid] = expf(a_end - m_new);
            if (tid == 0) { misc[1] = expf(bl_ + m_prev - m_new); misc[2] = m_new; }
        }
        __syncthreads();
        {
            const float decay = misc[1];
            for (int i = tid; i < 128 * 64; i += 256) {
                const int d = i >> 6, e = i & 63;
                float a = 0.f;
                for (int s = 0; s < 64; ++s) a += wst[s] * ks[s * 128 + d] * vs[s * 64 + e];
                C[i] = decay * C[i] + a;
            }
            if (tid < 128) {
                float a = 0.f;
                for (int s = 0; s < 64; ++s) a += wst[s] * ks[s * 128 + tid];
                nst[tid] = decay * nst[tid] + a;
            }
        }
        __syncthreads();
        if (tid == 0) misc[0] = misc[2];
        __syncthreads();
    }
}
__global__ void __launch_bounds__(256) k_mlstm_norm(float* mix, const float* norm_g) {
    const int gw = (blockIdx.x * 256 + threadIdx.x) >> 6, lane = threadIdx.x & 63;
    const int h = gw & 3, t = gw >> 2;
    float* row = mix + (size_t)t * 1024 + 512 + h * 128;
    const float a = row[lane], b2 = row[64 + lane];
    const float ss = wave_sum(a * a + b2 * b2);
    const float r = rsqrtf(ss * (1.f / 128.f) + EPS);
    row[lane] = a * r * norm_g[h * 128 + lane];
    row[64 + lane] = b2 * r * norm_g[h * 128 + 64 + lane];
}

__global__ void __launch_bounds__(256) k_resid(const float* xin, const float* y, const float* mod, int g_off, float* xout, int tok0, int ntok) {
    const size_t i = (size_t)blockIdx.x * 256 + threadIdx.x;
    if (i >= (size_t)ntok * D) return;
    const int tl = i / D, col = i % D, t = tok0 + tl, b = t / SEQ;
    xout[(size_t)t * D + col] = xin[(size_t)t * D + col] + mod[b * 6144 + g_off + col] * y[i];
}

__global__ void __launch_bounds__(256) k_topk(const float* scores, int* idx, float* gate, int ntok) {
    const int gw = (blockIdx.x * 256 + threadIdx.x) >> 6, lane = threadIdx.x & 63;
    if (gw >= ntok * PH) return;
    const float* s = scores + (size_t)gw * 256;
    float sv[2][16]; int si[2][16];
#pragma unroll
    for (int p = 0; p < 2; ++p) {
        float a = s[p * 128 + lane], b = s[p * 128 + 64 + lane];
#pragma unroll
        for (int k = 0; k < 16; ++k) {
            const float m = fmaxf(a, b);
            const float wm = wave_max(m);
            int cand = (a == wm) ? lane : ((b == wm) ? lane + 64 : 1 << 20);
#pragma unroll
            for (int o = 1; o < 64; o <<= 1) cand = min(cand, __shfl_xor(cand, o));
            sv[p][k] = wm; si[p][k] = cand;
            if (cand == lane) a = -INFINITY;
            if (cand == lane + 64) b = -INFINITY;
        }
    }
    float cv[4];
#pragma unroll
    for (int r = 0; r < 4; ++r) {
        const int cidx = lane + 64 * r, i = cidx >> 4, j = cidx & 15;
        float vi = 0.f, vj = 0.f;
#pragma unroll
        for (int k = 0; k < 16; ++k) { vi = (i == k) ? sv[0][k] : vi; vj = (j == k) ? sv[1][k] : vj; }
        cv[r] = vi + vj;
    }
    float ts[16]; int tp[16];
#pragma unroll
    for (int k = 0; k < 16; ++k) {
        const float m = fmaxf(fmaxf(cv[0], cv[1]), fmaxf(cv[2], cv[3]));
        const float wm = wave_max(m);
        int cand = 1 << 20;
#pragma unroll
        for (int r = 3; r >= 0; --r) cand = (cv[r] == wm) ? lane + 64 * r : cand;
#pragma unroll
        for (int o = 1; o < 64; o <<= 1) cand = min(cand, __shfl_xor(cand, o));
        ts[k] = wm; tp[k] = cand;
#pragma unroll
        for (int r = 0; r < 4; ++r) if (cand == lane + 64 * r) cv[r] = -INFINITY;
    }
    float se = 0.f;
#pragma unroll
    for (int k = 0; k < 16; ++k) se += expf(ts[k] - ts[0]);
    if (lane < 16) {
        float myts = 0.f; int mytp = 0;
#pragma unroll
        for (int k = 0; k < 16; ++k) { myts = (lane == k) ? ts[k] : myts; mytp = (lane == k) ? tp[k] : mytp; }
        const int i = mytp >> 4, j = mytp & 15;
        int ii = 0, jj = 0;
#pragma unroll
        for (int k = 0; k < 16; ++k) { ii = (i == k) ? si[0][k] : ii; jj = (j == k) ? si[1][k] : jj; }
        idx[(size_t)gw * 16 + lane] = ii * 128 + jj;
        gate[(size_t)gw * 16 + lane] = expf(myts - ts[0]) / se;
    }
}

__global__ void __launch_bounds__(256) k_peer(const float* h2, const int* idx, const float* gate, const float* U, const float* V,
                                              const float* mod, const float* final_g, float* xio, int tok0, int ntok) {
    const int wave = (blockIdx.x * 256 + threadIdx.x) >> 6, lane = threadIdx.x & 63;
    if (wave >= ntok) return;
    const int t = tok0 + wave, b = t / SEQ;
    float hv[16], acc[16];
#pragma unroll
    for (int j = 0; j < 16; ++j) { hv[j] = h2[(size_t)wave * D + lane + 64 * j]; acc[j] = 0.f; }
    for (int e = 0; e < 128; ++e) {
        const int id = idx[(size_t)wave * 128 + e];
        const float g = gate[(size_t)wave * 128 + e];
        const float* ur = U + (size_t)id * D;
        float dot = 0.f;
#pragma unroll
        for (int j = 0; j < 16; ++j) dot += ur[lane + 64 * j] * hv[j];
        dot = wave_sum(dot);
        const float cf = g * gelu_tanh_f(dot);
        const float* vr = V + (size_t)id * D;
#pragma unroll
        for (int j = 0; j < 16; ++j) acc[j] += cf * vr[lane + 64 * j];
    }
    float* xr = xio + (size_t)t * D;
    float ss = 0.f;
#pragma unroll
    for (int j = 0; j < 16; ++j) {
        const int col = lane + 64 * j;
        acc[j] = xr[col] + mod[b * 6144 + 5 * 1024 + col] * acc[j];
        ss += acc[j] * acc[j];
    }
    ss = wave_sum(ss);
    const float r = rsqrtf(ss * (1.f / D) + EPS);
#pragma unroll
    for (int j = 0; j < 16; ++j) { const int col = lane + 64 * j; xr[col] = acc[j] * r * final_g[col]; }
}

extern "C" void kernel_launch(void* const* d_in, const int* in_sizes, int n_in, void* d_out, int out_size, void* d_ws, size_t ws_size,
                              hipStream_t stream) {
    const float* x = (const float*)d_in[0];
    const float* c = (const float*)d_in[1];
    const float* w_ada = (const float*)d_in[2];
    const float* b_ada = (const float*)d_in[3];
    const float* norm1_g = (const float*)d_in[4];
    const float* norm2_g = (const float*)d_in[5];
    const float* w_in = (const float*)d_in[6];
    const float* conv_w = (const float*)d_in[7];
    const float* conv_b = (const float*)d_in[8];
    const float* b_ig = (const float*)d_in[9];
    const float* b_fg = (const float*)d_in[10];
    const float* lq1 = (const float*)d_in[11];
    const float* lk1 = (const float*)d_in[12];
    const float* lq2 = (const float*)d_in[13];
    const float* lk2 = (const float*)d_in[14];
    const float* sub_g = (const float*)d_in[15];
    const float* mnorm_g = (const float*)d_in[16];
    const float* w_out = (const float*)d_in[17];
    const float* w_q = (const float*)d_in[18];
    const float* sub_keys = (const float*)d_in[19];
    const float* U = (const float*)d_in[20];
    const float* V = (const float*)d_in[21];
    const float* rel_bias = (const float*)d_in[22];
    const float* final_g = (const float*)d_in[23];
    float* out = (float*)d_out;

    static bool once = false;
    if (!once) {
        once = true;
        hipFuncSetAttribute((const void*)k_mlstm, hipFuncAttributeMaxDynamicSharedMemorySize, ML_LDS);
        if (ws_size < (size_t)400 << 20) fprintf(stderr, "kernel_launch: ws_size %zu too small\n", ws_size);
    }
    char* ws = (char*)d_ws;
    const size_t MiB = 1 << 20;
    float* mod = (float*)(ws);
    float* hbuf = (float*)(ws + 1 * MiB);
    float* proj = (float*)(ws + 33 * MiB);
    float* mix = (float*)(ws + 146 * MiB);
    float* ybuf = (float*)(ws + 178 * MiB);
    float* qbuf = (float*)(ws + 210 * MiB);
    float* sbuf = (float*)(ws + 274 * MiB);
    int* idx = (int*)(ws + 338 * MiB);
    float* gate = (float*)(ws + 342 * MiB);

    k_mod<<<6144 / 256, 256, 0, stream>>>(c, w_ada, b_ada, mod);
    for (int g = 0; g < BATCH / GB; ++g) {
        const int tok0 = g * GT;
        k_norm_mod<<<GT / 4, 256, 0, stream>>>(x, norm1_g, mod, 0, 1024, hbuf, tok0, GT);
        k_gemm<<<dim3((DPROJ + 63) / 64, GT / 64, 1), 256, 0, stream>>>(hbuf, D, w_in, DPROJ, proj, DPROJ, GT, DPROJ, D, 0, 0, 0, 0);
        k_attn<<<GB * 4 * SEQ / 4, 256, 0, stream>>>(proj, rel_bias, lq1, lk1, lq2, lk2, sub_g, mix);
        k_mlstm<<<GB * 4 * 2, 256, ML_LDS, stream>>>(proj, conv_w, conv_b, b_ig, b_fg, mix);
        k_mlstm_norm<<<GT * 4 / 4, 256, 0, stream>>>(mix, mnorm_g);
        k_gemm<<<dim3(D / 64, GT / 64, 1), 256, 0, stream>>>(mix, D, w_out, D, ybuf, D, GT, D, D, 0, 0, 0, 0);
        k_resid<<<GT * D / 256, 256, 0, stream>>>(x, ybuf, mod, 2048, out, tok0, GT);
        k_norm_mod<<<GT / 4, 256, 0, stream>>>(out, norm2_g, mod, 3072, 4096, hbuf, tok0, GT);
        k_gemm<<<dim3(2048 / 64, GT / 64, 1), 256, 0, stream>>>(hbuf, D, w_q, 2048, qbuf, 2048, GT, 2048, D, 0, 0, 0, 0);
        k_gemm<<<dim3(2, GT / 64, 16), 256, 0, stream>>>(qbuf, 2048, sub_keys, 128, sbuf, 2048, GT, 128, 128, 128, 128 * 128, 128, 1);
        k_topk<<<GT * PH / 4, 256, 0, stream>>>(sbuf, idx, gate, GT);
        k_peer<<<GT / 4, 256, 0, stream>>>(hbuf, idx, gate, U, V, mod, final_g, out, tok0, GT);
    }
}
```
